# Optimizing an MI355X kernel written in HIP

```python
import math
import jax, jax.numpy as jnp
from jax import lax
import numpy as np

D_MODEL = 1024
BATCH = 2
SEQ = 8192
DEPTH = 2

MEM_LEN = 256
N_MIXERS = 2
N_A = (DEPTH + N_MIXERS - 1) // N_MIXERS
N_B = DEPTH // N_MIXERS
ROPE_THETA = 10000.0
NORM_EPS = 1e-6
DA_HEADS = D_MODEL // 128
DA_QK_DIM = 64
DA_V_DIM = 2 * DA_QK_DIM
DA_Q_BLOCK = 128
DB_PAIRS = ((128, 1), (512, 4), (2048, 16))
DB_SLOTS = 8
DB_HEAD_DIM = 128
DB_Q_BLOCK = 64
XA_HEADS = 4
XA_HEAD_DIM = D_MODEL // XA_HEADS
D_FF = 4 * D_MODEL

kernel_name = 'hybrid_diff_dilated_encoder'


def rms_norm(x, g):
    xf = x.astype(jnp.float32)
    y = xf * lax.rsqrt(jnp.mean(xf * xf, axis=-1, keepdims=True) + NORM_EPS)
    return (y * g.astype(jnp.float32)).astype(x.dtype)


def rope(t, positions):
    dh = t.shape[-1]
    inv = ROPE_THETA ** (-jnp.arange(0, dh, 2, dtype=jnp.float32) / dh)
    ang = positions.astype(jnp.float32)[..., None] * inv
    ang = ang.reshape(ang.shape[:2] + (1,) * (t.ndim - 3) + (dh // 2,))
    cos, sin = jnp.cos(ang), jnp.sin(ang)
    tf = t.astype(jnp.float32)
    t1, t2 = tf[..., : dh // 2], tf[..., dh // 2:]
    return jnp.concatenate([t1 * cos - t2 * sin, t1 * sin + t2 * cos], axis=-1).astype(t.dtype)


def diff_attention(h, positions, w_qkv, lam, subln_g, w_o, lambda_init):
    B, S, _ = h.shape
    H, dq, dv = DA_HEADS, DA_QK_DIM, DA_V_DIM
    qkv = h @ w_qkv
    q, k, v = jnp.split(qkv, [H * 2 * dq, 2 * H * 2 * dq], axis=-1)
    q = rope(q.reshape(B, S, H, 2, dq), positions)
    k = rope(k.reshape(B, S, H, 2, dq), positions)
    v = v.reshape(B, S, H, dv)
    lamf = lam.astype(jnp.float32)
    lam_full = jnp.exp(jnp.sum(lamf[0] * lamf[1])) - jnp.exp(jnp.sum(lamf[2] * lamf[3])) + lambda_init
    nblk = S // DA_Q_BLOCK
    qb = q.reshape(B, nblk, DA_Q_BLOCK, H, 2, dq).transpose(1, 0, 2, 3, 4, 5)
    scale = dq ** -0.5

    def block(qi):
        s = jnp.einsum('bqhcd,bkhcd->bhcqk', qi, k).astype(jnp.float32) * scale
        p = jax.nn.softmax(s, axis=-1)
        a = (p[:, :, 0] - lam_full * p[:, :, 1]).astype(v.dtype)
        return jnp.einsum('bhqk,bkhd->bqhd', a, v)

    o = lax.map(block, qb)
    o = o.transpose(1, 0, 2, 3, 4).reshape(B, S, H, dv)
    o = rms_norm(o, subln_g) * (1.0 - lambda_init)
    return o.reshape(B, S, H * dv) @ w_o


def banded_attention(q, k, v, radius):
    N, L, H, Dh = q.shape
    QB = DB_Q_BLOCK
    nb = -(-L // QB)
    Lp = nb * QB
    KB = QB + 2 * radius
    q = jnp.pad(q, ((0, 0), (0, Lp - L), (0, 0), (0, 0)))
    kpad = ((0, 0), (radius, Lp - L + radius), (0, 0), (0, 0))
    k = jnp.pad(k, kpad)
    v = jnp.pad(v, kpad)
    idx = (jnp.arange(nb) * QB)[:, None] + jnp.arange(KB)[None, :]
    kb = k[:, idx]
    vb = v[:, idx]
    qb = q.reshape(N, nb, QB, H, Dh)
    rel = jnp.arange(KB)[None, :] - radius - jnp.arange(QB)[:, None]
    key_pos = idx - radius
    mask = (jnp.abs(rel) <= radius)[None] & ((key_pos >= 0) & (key_pos < L))[:, None, :]
    s = jnp.einsum('nbqhd,nbkhd->nbhqk', qb, kb).astype(jnp.float32) * (Dh ** -0.5)
    s = jnp.where(mask[None, :, None], s, -jnp.inf)
    m = jnp.max(s, axis=-1, keepdims=True)
    p = jnp.exp(s - m)
    den = jnp.sum(p, axis=-1, keepdims=True)
    o = jnp.einsum('nbhqk,nbkhd->nbqhd', (p / den).astype(v.dtype), vb)
    lse = (m + jnp.log(den))[..., 0]
    o = o.reshape(N, Lp, H, Dh)[:, :L]
    lse = lse.transpose(0, 1, 3, 2).reshape(N, Lp, H)[:, :L]
    return o, lse


def dilated_group(q, k, v, dilation, radius):
    B, S, H, Dh = q.shape
    L = S // dilation

    def split(t):
        return t.reshape(B, L, dilation, H, Dh).transpose(0, 2, 1, 3, 4).reshape(B * dilation, L, H, Dh)

    o, lse = banded_attention(split(q), split(k), split(v), radius)
    o = o.reshape(B, dilation, L, H, Dh).transpose(0, 2, 1, 3, 4).reshape(B, S, H, Dh)
    lse = lse.reshape(B, dilation, L, H).transpose(0, 2, 1, 3).reshape(B, S, H)
    return o, lse


def dilated_attention(h, positions, w_qkv, w_o):
    B, S, _ = h.shape
    G, H, Dh = len(DB_PAIRS), DB_SLOTS, DB_HEAD_DIM
    qkv = (h @ w_qkv).reshape(B, S, 3, G, H, Dh)
    q = rope(qkv[:, :, 0], positions)
    k = rope(qkv[:, :, 1], positions)
    v = qkv[:, :, 2]
    outs, lses = [], []
    for g, (window, dil) in enumerate(DB_PAIRS):
        o, lse = dilated_group(q[:, :, g], k[:, :, g], v[:, :, g], dil, (window // 2) // dil)
        outs.append(o)
        lses.append(lse)
    wts = jax.nn.softmax(jnp.stack(lses), axis=0)
    o = jnp.einsum('gbsh,gbshd->bshd', wts, jnp.stack(outs).astype(jnp.float32)).astype(h.dtype)
    return o.reshape(B, S, H * Dh) @ w_o


def memory_cross_attention(h, mem, mem_g, wq, wkv, wo):
    B, S, _ = h.shape
    H, Dh = XA_HEADS, XA_HEAD_DIM
    M = mem.shape[1]
    mn = rms_norm(mem, mem_g)
    q = (h @ wq).reshape(B, S, H, Dh)
    kv = (mn @ wkv).reshape(B, M, 2, H, Dh)
    s = jnp.einsum('bqhd,bkhd->bhqk', q, kv[:, :, 0]).astype(jnp.float32) * (Dh ** -0.5)
    p = jax.nn.softmax(s, axis=-1).astype(h.dtype)
    o = jnp.einsum('bhqk,bkhd->bqhd', p, kv[:, :, 1])
    return o.reshape(B, S, H * Dh) @ wo


def squared_relu_mlp(h, w_up, w_down):
    return jnp.square(jax.nn.relu(h @ w_up)) @ w_down


def setup_inputs(seed: int = 0) -> dict:
    key = jax.random.key(seed)
    ks = jax.random.split(key, 24)

    def gain(k, shape):
        return 1.0 + 0.05 * jax.random.normal(k, shape, jnp.float32)

    def weight(k, shape, fan_in):
        return jax.random.normal(k, shape, jnp.float32) * (fan_in ** -0.5)

    D = D_MODEL
    da_w = DA_HEADS * DA_V_DIM
    db_w = len(DB_PAIRS) * DB_SLOTS * DB_HEAD_DIM
    xa_w = XA_HEADS * XA_HEAD_DIM
    x = jax.random.normal(ks[0], (BATCH, SEQ, D), jnp.float32)
    mem = jax.random.normal(ks[1], (BATCH, MEM_LEN, D), jnp.float32)
    positions = (jnp.arange(SEQ, dtype=jnp.int32)[None, :]
                 + jax.random.randint(ks[2], (BATCH, 1), 0, 1024, dtype=jnp.int32))
    return {
        'x': x,
        'mem': mem,
        'positions': positions,
        'mix_pre_g': gain(ks[3], (DEPTH, D)),
        'mix_post_g': gain(ks[4], (DEPTH, D)),
        'da_w_qkv': weight(ks[5], (N_A, D, 3 * da_w), D),
        'da_lambda': 0.1 * jax.random.normal(ks[6], (N_A, 4, DA_QK_DIM), jnp.float32),
        'da_subln_g': gain(ks[7], (N_A, DA_V_DIM)),
        'da_w_o': weight(ks[8], (N_A, da_w, D), da_w),
        'db_w_qkv': weight(ks[9], (N_B, D, 3 * db_w), D),
        'db_w_o': weight(ks[10], (N_B, DB_SLOTS * DB_HEAD_DIM, D), DB_SLOTS * DB_HEAD_DIM),
        'xa_pre_g': gain(ks[11], (DEPTH, D)),
        'mem_g': gain(ks[12], (DEPTH, D)),
        'xa_wq': weight(ks[13], (DEPTH, D, xa_w), D),
        'xa_wkv': weight(ks[14], (DEPTH, D, 2 * xa_w), D),
        'xa_wo': weight(ks[15], (DEPTH, xa_w, D), xa_w),
        'xa_post_g': gain(ks[16], (DEPTH, D)),
        'ffn_pre_g': gain(ks[17], (DEPTH, D)),
        'w_up': weight(ks[18], (DEPTH, D, D_FF), D),
        'w_down': weight(ks[19], (DEPTH, D_FF, D), D_FF),
        'ffn_post_g': gain(ks[20], (DEPTH, D)),
    }


def reference(x, mem, positions, mix_pre_g, mix_post_g, da_w_qkv, da_lambda, da_subln_g, da_w_o,
              db_w_qkv, db_w_o, xa_pre_g, mem_g, xa_wq, xa_wkv, xa_wo, xa_post_g,
              ffn_pre_g, w_up, w_down, ffn_post_g):
    for i in range(DEPTH):
        j = i // N_MIXERS
        h = rms_norm(x, mix_pre_g[i])
        if i % N_MIXERS == 0:
            lambda_init = 0.8 - 0.6 * math.exp(-0.3 * i)
            mix = diff_attention(h, positions, da_w_qkv[j], da_lambda[j], da_subln_g[j], da_w_o[j], lambda_init)
        else:
            mix = dilated_attention(h, positions, db_w_qkv[j], db_w_o[j])
        x = x + rms_norm(mix, mix_post_g[i])
        h = rms_norm(x, xa_pre_g[i])
        x = x + rms_norm(memory_cross_attention(h, mem, mem_g[i], xa_wq[i], xa_wkv[i], xa_wo[i]), xa_post_g[i])
        h = rms_norm(x, ffn_pre_g[i])
        x = x + rms_norm(squared_relu_mlp(h, w_up[i], w_down[i]), ffn_post_g[i])
    return x
```

```cpp
#include <hip/hip_runtime.h>
#include <cstdio>
#include <cstdint>
namespace pg8 {
#define PG8_LAS __attribute__((address_space(3)))
typedef unsigned short bf16_t;
typedef short bf16x8 __attribute__((ext_vector_type(8)));
typedef float f32x4 __attribute__((ext_vector_type(4)));
typedef unsigned u32x4 __attribute__((ext_vector_type(4)));
constexpr int BM = 256, BK = 64, HALF = 128, HTB = HALF * BK * 2  , STAGE_BYTES = 8 * HTB, NXCD = 8, WGM = 8;

__host__ __device__ __forceinline__ int lds_byte(int r, int c) { const int st = (r >> 4) * 2 + (c >> 5), rr = r & 15, cc = c & 31, ob = rr * 64 + cc * 2; return st * 1024 + (ob ^ (((ob >> 9) & 1) << 5)); }
__host__ __device__ __forceinline__ void stage_rc(int b, int& R, int& C) { const int st = b / 1024, sb = b % 1024, swz = sb ^ (((sb >> 9) & 1) << 5); R = (st >> 1) * 16 + swz / 64; C = (st & 1) * 32 + (swz % 64) / 2; }
__host__ __device__ __forceinline__ int perm32(int rho) { const int n = rho >> 4, i = rho & 15; return 8 * (i >> 2) + 4 * n + (i & 3); }

struct Unit { int pm, pn; };
struct Gemm { const bf16_t* A; const bf16_t* Bt; int M, N, K; };

struct StaticOrder {
    int nM, nN, nwg, G, c;
    __host__ __device__ void init(int M, int N, int G_, int c_) { nM = M / BM; nN = N / BM; nwg = nM * nN; G = G_; c = c_; }
    __host__ __device__ bool next(int i, Unit& u) const {
        const long L = (long)i * G + c; if (L >= nwg) return false;
        int wgid = (int)L; { const int q = nwg / NXCD, r = nwg % NXCD, xcd = wgid % NXCD, off = wgid / NXCD; wgid = (xcd < r ? xcd * (q + 1) : r * (q + 1) + (xcd - r) * q) + off; }
        const int nig = WGM * nN, gid = wgid / nig, fm = gid * WGM, gsz = (nM - fm) < WGM ? (nM - fm) : WGM;
        u.pm = fm + ((wgid % nig) % gsz); u.pn = (wgid % nig) / gsz; return true;
    }
    __device__ __forceinline__ void a_ready(const Unit&) const {}
    __device__ __forceinline__ void done(const Unit&) const {}
};

__device__ __forceinline__ unsigned cvt_pk_bf16(float lo, float hi) { unsigned r; asm volatile("v_cvt_pk_bf16_f32 %0, %1, %2" : "=v"(r) : "v"(lo), "v"(hi)); return r; }

struct EpiF32 {
    static constexpr bool PERM = false, AFTER_DRAIN = false;
    float* C; int ldc;
    __device__ __forceinline__ void operator()(const f32x4 (&acc)[2][2][4][2], const Unit& u, int wr, int wc, int fr, int fq) const {
        const int row0 = u.pm * BM + wr * 64 + fr, col0 = u.pn * BM + wc * 32 + 4 * fq;
#pragma unroll
        for (int ai = 0; ai < 2; ++ai)
#pragma unroll
            for (int m = 0; m < 4; ++m) { float* rowp = C + (size_t)(row0 + ai * HALF + m * 16) * ldc + col0;
#pragma unroll
                for (int bj = 0; bj < 2; ++bj)
#pragma unroll
                    for (int n = 0; n < 2; ++n) *(f32x4*)(rowp + bj * HALF + n * 16) = acc[ai][bj][m][n]; }
    }
};

__device__ __forceinline__ void rope_sincos(float x, float& s, float& c) {
    const float k = rintf(x * 0.15915494309189535f);
    float r = fmaf(-k, 6.28125f, x);
    r = fmaf(-k, 1.9353071795864769e-3f, r);
    const float rev = r * 0.15915494309189535f;
    s = __builtin_amdgcn_sinf(rev); c = __builtin_amdgcn_cosf(rev);
}

struct EpiBf16G {
    static constexpr bool PERM = true, AFTER_DRAIN = false;
    bf16_t* O; int ldc; int split_cols; size_t split_stride; float scale0; int act; int rope_dh; const int* pos; const float* inv;
    __device__ __forceinline__ void operator()(const f32x4 (&acc)[2][2][4][2], const Unit& u, int wr, int wc, int fr, int fq) const {
        const int row0 = u.pm * BM + wr * 64 + fr; int colt = u.pn * BM; bf16_t* base = O; int t = 0;
        if (split_cols) { t = colt / split_cols; base += (size_t)t * split_stride; colt -= t * split_cols; }
        const float sc = (t == 0) ? scale0 : 1.f;
        const int col0 = colt + wc * 32 + 8 * fq;
        const bool rope = (rope_dh != 0) && (t < 2);
        f32x4 inv4 = (f32x4){0.f, 0.f, 0.f, 0.f};
        if (rope) inv4 = *(const f32x4*)(inv + ((col0 & (rope_dh - 1)) >> 1));
#pragma unroll
        for (int ai = 0; ai < 2; ++ai)
#pragma unroll
            for (int m = 0; m < 4; ++m) { const int row = row0 + ai * HALF + m * 16; bf16_t* rowp = base + (size_t)row * ldc + col0;
                float cs0 = 1.f, cs1 = 1.f, cs2 = 1.f, cs3 = 1.f, sn0 = 0.f, sn1 = 0.f, sn2 = 0.f, sn3 = 0.f;
                if (rope) { const float p = (float)pos[row];
                    rope_sincos(p * inv4[0], sn0, cs0); rope_sincos(p * inv4[1], sn1, cs1); rope_sincos(p * inv4[2], sn2, cs2); rope_sincos(p * inv4[3], sn3, cs3); }
#pragma unroll
                for (int bj = 0; bj < 2; ++bj) { f32x4 v0 = acc[ai][bj][m][0], v1 = acc[ai][bj][m][1];
                    if (rope) { const f32x4 a = v0, b = v1;
                        v0[0] = a[0] * cs0 - a[1] * sn0; v0[1] = a[0] * sn0 + a[1] * cs0; v0[2] = a[2] * cs1 - a[3] * sn1; v0[3] = a[2] * sn1 + a[3] * cs1;
                        v1[0] = b[0] * cs2 - b[1] * sn2; v1[1] = b[0] * sn2 + b[1] * cs2; v1[2] = b[2] * cs3 - b[3] * sn3; v1[3] = b[2] * sn3 + b[3] * cs3; }
                    if (act == 1) {
#pragma unroll
                        for (int e = 0; e < 4; ++e) { const float x0 = fmaxf(v0[e], 0.f), x1 = fmaxf(v1[e], 0.f); v0[e] = x0 * x0; v1[e] = x1 * x1; } }
                    v0 = v0 * sc; v1 = v1 * sc; u32x4 w; w.x = cvt_pk_bf16(v0[0], v0[1]); w.y = cvt_pk_bf16(v0[2], v0[3]); w.z = cvt_pk_bf16(v1[0], v1[1]); w.w = cvt_pk_bf16(v1[2], v1[3]);
                    *(u32x4*)(rowp + bj * HALF) = w; } }
    }
};

template <class Epi, class Sched, bool ALIGN_EPI = false, bool SP2 = false>
__device__ __forceinline__ void gemm_phase(PG8_LAS unsigned char* lds, const Gemm g, const Sched& S, const Epi& E) {
    int tid_ = threadIdx.x; asm volatile("" : "+v"(tid_));
    const int tid = tid_, wid = __builtin_amdgcn_readfirstlane(tid >> 6), lane = tid & 63, wr = wid >> 2, wc = wid & 3, fr = lane & 15, fq = lane >> 4;
    const int K = g.K, nt = K / BK;
    unsigned voffA[2], voffB[2];
#pragma unroll
    for (int i = 0; i < 2; ++i) { int R, C; stage_rc(tid * 16 + i * 8192, R, C); const int Rb = Epi::PERM ? ((R & ~31) + perm32(R & 31)) : R;
        voffA[i] = (unsigned)(R * K + C) * 2u; voffB[i] = (unsigned)(Rb * K + C) * 2u; }
    const size_t kstep = (size_t)(BK * 2);
    const size_t hstep = (size_t)HALF * K * 2;
    const size_t tstep = 2 * hstep;
    const unsigned ldsw = (unsigned)wid * 1024u;
    const int aoff = lds_byte(wr * 64 + fr, fq * 8), boff = lds_byte(wc * 32 + fr, fq * 8);
#define PG8_SA(b, h) (((b) * 2 + (h)) * HTB)
#define PG8_SB(b, h) ((4 + (b) * 2 + (h)) * HTB)
#define PG8_STAGE(bufoff, gbase, voff) do { _Pragma("unroll") for (int _i = 0; _i < 2; ++_i) \
        __builtin_amdgcn_global_load_lds((const unsigned*)((const char*)(gbase) + (voff)[_i]), (PG8_LAS unsigned*)(lds + (bufoff) + ldsw + _i * 8192), 16, 0, 0); } while (0)
#define PG8_LDA(dst, b, h) do { _Pragma("unroll") for (int m = 0; m < 4; ++m) _Pragma("unroll") for (int k = 0; k < 2; ++k) dst[m][k] = *(const PG8_LAS bf16x8*)(lds + PG8_SA(b, h) + aoff + m * 2048 + k * 1024); } while (0)
#define PG8_LDB(dst, b, h) do { _Pragma("unroll") for (int n = 0; n < 2; ++n) _Pragma("unroll") for (int k = 0; k < 2; ++k) dst[n][k] = *(const PG8_LAS bf16x8*)(lds + PG8_SB(b, h) + boff + n * 2048 + k * 1024); } while (0)
#define PG8_MMA(ai, bj, At, Bt) do { __builtin_amdgcn_s_setprio(1); _Pragma("unroll") for (int m = 0; m < 4; ++m) _Pragma("unroll") for (int n = 0; n < 2; ++n) _Pragma("unroll") for (int k = 0; k < 2; ++k) \
        acc[ai][bj][m][n] = __builtin_amdgcn_mfma_f32_16x16x32_bf16(Bt[n][k], At[m][k], acc[ai][bj][m][n], 0, 0, 0); __builtin_amdgcn_s_setprio(0); } while (0)
#define PG8_WAIT_V(n) asm volatile("s_waitcnt vmcnt(" #n ")" ::: "memory")
#define PG8_WAIT_L(n) asm volatile("s_waitcnt lgkmcnt(" #n ")" ::: "memory")
#define PG8_BAR __builtin_amdgcn_s_barrier()
#define PG8_SCHED __builtin_amdgcn_sched_barrier(0)
    Unit cur, nxt; int ui = 0;
    if (!S.next(0, cur)) return;
    f32x4 acc[2][2][4][2];
#pragma unroll
    for (int a = 0; a < 2; ++a)
#pragma unroll
        for (int b = 0; b < 2; ++b)
#pragma unroll
            for (int m = 0; m < 4; ++m)
#pragma unroll
                for (int n = 0; n < 2; ++n) acc[a][b][m][n] = (f32x4){0.f, 0.f, 0.f, 0.f};
    bf16x8 At[4][2], B0[2][2], B1[2][2];
    const char* cA = (const char*)g.A + (size_t)cur.pm * tstep; const char* cB = (const char*)g.Bt + (size_t)cur.pn * tstep;
    S.a_ready(cur);
    if constexpr (SP2) {
        PG8_STAGE(PG8_SB(0, 0), cB, voffB); PG8_STAGE(PG8_SB(0, 1), cB + hstep, voffB); PG8_STAGE(PG8_SA(0, 0), cA, voffA); PG8_STAGE(PG8_SA(0, 1), cA + hstep, voffA);
        if (wr == 1) PG8_BAR;
        PG8_WAIT_V(2); PG8_BAR;
        PG8_STAGE(PG8_SB(1, 0), cB + kstep, voffB); PG8_STAGE(PG8_SA(1, 0), cA + kstep, voffA); PG8_STAGE(PG8_SB(1, 1), cB + hstep + kstep, voffB);
        PG8_WAIT_V(6); PG8_BAR;
    } else {
        PG8_STAGE(PG8_SB(0, 0), cB, voffB); PG8_STAGE(PG8_SA(0, 0), cA, voffA); PG8_STAGE(PG8_SB(0, 1), cB + hstep, voffB); PG8_STAGE(PG8_SA(0, 1), cA + hstep, voffA);
        if (wr == 1) PG8_BAR;
        PG8_WAIT_V(4); PG8_BAR;
        PG8_STAGE(PG8_SB(1, 0), cB + kstep, voffB); PG8_STAGE(PG8_SA(1, 0), cA + kstep, voffA); PG8_STAGE(PG8_SB(1, 1), cB + hstep + kstep, voffB);
        PG8_WAIT_V(6); PG8_BAR;
    }
    for (;;) {
        const bool has_next = S.next(ui + 1, nxt);
        const char* nA = has_next ? (const char*)g.A + (size_t)nxt.pm * tstep : cA; const char* nB = has_next ? (const char*)g.Bt + (size_t)nxt.pn * tstep : cB;
        for (int t = 0; t < nt; t += 2) {
            const bool last = (t == nt - 2);
            const char* a1 = cA + (size_t)(t + 1) * kstep;
            const char* a2 = last ? nA : cA + (size_t)(t + 2) * kstep; const char* b2 = last ? nB : cB + (size_t)(t + 2) * kstep;
            const char* a3 = a2 + kstep; const char* b3 = b2 + kstep;
            if (last && has_next) S.a_ready(nxt);
            if constexpr (SP2) {
            PG8_LDB(B0, 0, 0); PG8_LDB(B1, 0, 1); PG8_SCHED; PG8_LDA(At, 0, 0); PG8_STAGE(PG8_SA(1, 1), a1 + hstep, voffA);
            PG8_WAIT_V(8); PG8_WAIT_L(0); PG8_BAR; PG8_MMA(0, 0, At, B0); PG8_MMA(0, 1, At, B1); PG8_BAR; PG8_SCHED;
            PG8_LDA(At, 0, 1); PG8_STAGE(PG8_SB(0, 0), b2, voffB); PG8_STAGE(PG8_SB(0, 1), b2 + hstep, voffB); PG8_STAGE(PG8_SA(0, 0), a2, voffA);
            PG8_WAIT_V(8); PG8_WAIT_L(0); PG8_BAR; PG8_MMA(1, 0, At, B0); PG8_MMA(1, 1, At, B1); PG8_BAR; PG8_SCHED;
            PG8_LDB(B0, 1, 0); PG8_LDB(B1, 1, 1); PG8_SCHED; PG8_LDA(At, 1, 0); PG8_STAGE(PG8_SA(0, 1), a2 + hstep, voffA);
            PG8_WAIT_V(8); PG8_WAIT_L(0); PG8_BAR; PG8_MMA(0, 0, At, B0); PG8_MMA(0, 1, At, B1); PG8_BAR; PG8_SCHED;
            PG8_LDA(At, 1, 1); PG8_STAGE(PG8_SB(1, 0), b3, voffB); PG8_STAGE(PG8_SB(1, 1), b3 + hstep, voffB); PG8_STAGE(PG8_SA(1, 0), a3, voffA);
            PG8_WAIT_V(8); PG8_WAIT_L(0); PG8_BAR; PG8_MMA(1, 0, At, B0); PG8_MMA(1, 1, At, B1); PG8_BAR; PG8_SCHED;
            } else {
            PG8_LDB(B0, 0, 0); PG8_SCHED; PG8_LDA(At, 0, 0); PG8_STAGE(PG8_SA(1, 1), a1 + hstep, voffA);
            PG8_WAIT_L(8); PG8_BAR; PG8_WAIT_L(0); PG8_MMA(0, 0, At, B0); PG8_BAR; PG8_SCHED;
            PG8_LDB(B1, 0, 1); PG8_STAGE(PG8_SB(0, 0), b2, voffB);
            PG8_BAR; PG8_WAIT_L(0); PG8_MMA(0, 1, At, B1); PG8_BAR;
            PG8_LDA(At, 0, 1); PG8_STAGE(PG8_SA(0, 0), a2, voffA);
            PG8_BAR; PG8_WAIT_L(0); PG8_MMA(1, 0, At, B0); PG8_BAR; PG8_SCHED;
            PG8_STAGE(PG8_SB(0, 1), b2 + hstep, voffB);
            PG8_WAIT_V(6); PG8_BAR; PG8_MMA(1, 1, At, B1); PG8_BAR;
            PG8_LDB(B0, 1, 0); PG8_SCHED; PG8_LDA(At, 1, 0); PG8_STAGE(PG8_SA(0, 1), a2 + hstep, voffA);
            PG8_WAIT_L(8); PG8_BAR; PG8_WAIT_L(0); PG8_MMA(0, 0, At, B0); PG8_BAR; PG8_SCHED;
            PG8_LDB(B1, 1, 1); PG8_STAGE(PG8_SB(1, 0), b3, voffB);
            PG8_BAR; PG8_WAIT_L(0); PG8_MMA(0, 1, At, B1); PG8_BAR;
            PG8_LDA(At, 1, 1); PG8_STAGE(PG8_SA(1, 0), a3, voffA);
            PG8_BAR; PG8_WAIT_L(0); PG8_MMA(1, 0, At, B0); PG8_BAR; PG8_SCHED;
            PG8_STAGE(PG8_SB(1, 1), b3 + hstep, voffB);
            PG8_WAIT_V(6); PG8_BAR; PG8_MMA(1, 1, At, B1); PG8_BAR;
            }
        }
        if constexpr (ALIGN_EPI) { if (wr == 0) PG8_BAR; }
        if constexpr (!Epi::AFTER_DRAIN) { E(acc, cur, wr, wc, fr, fq); S.done(cur); }
        if (!has_next) break;
#pragma unroll
        for (int a = 0; a < 2; ++a)
#pragma unroll
            for (int b = 0; b < 2; ++b)
#pragma unroll
                for (int m = 0; m < 4; ++m)
#pragma unroll
                    for (int n = 0; n < 2; ++n) acc[a][b][m][n] = (f32x4){0.f, 0.f, 0.f, 0.f};
        cur = nxt; cA = nA; cB = nB; ++ui;
        if constexpr (ALIGN_EPI) { if (wr == 1) PG8_BAR; }
    }
    PG8_WAIT_V(0);
    if constexpr (!ALIGN_EPI) { if (wr == 0) PG8_BAR; }
    PG8_BAR;
    if constexpr (Epi::AFTER_DRAIN) { E.fused(acc, cur, wr, wc, fr, fq, lds, wid, lane); S.done(cur); }
#undef PG8_SA
#undef PG8_SB
#undef PG8_STAGE
#undef PG8_LDA
#undef PG8_LDB
#undef PG8_MMA
#undef PG8_WAIT_V
#undef PG8_WAIT_L
#undef PG8_BAR
#undef PG8_SCHED
}
}
namespace att {
using bf16 = unsigned short;
using bf16x8 = __attribute__((ext_vector_type(8))) short;
using s16x4  = __attribute__((ext_vector_type(4))) short;
using f32x16 = __attribute__((ext_vector_type(16))) float;
using u32x4  = __attribute__((ext_vector_type(4))) unsigned;
constexpr int LD = 1024;
constexpr float NEG = -1e30f;
#define KSWZ(row, colB) ((row) * 256 + ((colB) ^ (((row) & 7) << 4)))
#define SBAR() __builtin_amdgcn_sched_barrier(0)
__device__ __forceinline__ int crow(int r, int hi) { return (r & 3) + 8 * (r >> 2) + 4 * hi; }
__device__ __forceinline__ unsigned cvtpk(float lo, float hi) { unsigned r; asm volatile("v_cvt_pk_bf16_f32 %0, %1, %2" : "=v"(r) : "v"(lo), "v"(hi)); return r; }
#define ATT_GAS __attribute__((address_space(1)))
__device__ __forceinline__ bf16x8 ld8(const bf16* p) { return *(const ATT_GAS bf16x8*)p; }
__device__ __forceinline__ void st16(bf16* p, bf16 v) { *(ATT_GAS bf16*)p = v; }
__device__ __forceinline__ float bf2f(bf16 u) { return __uint_as_float(((unsigned)u) << 16); }
__device__ __forceinline__ bf16 f2bf(float f) { unsigned u = __float_as_uint(f); return (bf16)((u + 0x7fffu + ((u >> 16) & 1u)) >> 16); }
__device__ __forceinline__ float swapmax(float v) { auto rr = __builtin_amdgcn_permlane32_swap(__float_as_uint(v), __float_as_uint(v), false, false); return fmaxf(__uint_as_float(rr[0]), __uint_as_float(rr[1])); }
__device__ __forceinline__ float swapadd(float v) { auto rr = __builtin_amdgcn_permlane32_swap(__float_as_uint(v), __float_as_uint(v), false, false); return __uint_as_float(rr[0]) + __uint_as_float(rr[1]); }
#define PK4(P, BASE, OUT) do { unsigned a0_ = cvtpk(P[BASE + 0], P[BASE + 1]), a1_ = cvtpk(P[BASE + 2], P[BASE + 3]);   \
    unsigned b0_ = cvtpk(P[BASE + 4], P[BASE + 5]), b1_ = cvtpk(P[BASE + 6], P[BASE + 7]);                              \
    auto r0_ = __builtin_amdgcn_permlane32_swap(a0_, b0_, false, false); auto r1_ = __builtin_amdgcn_permlane32_swap(a1_, b1_, false, false); \
    u32x4 w_ = {r0_[0], r1_[0], r0_[1], r1_[1]}; OUT = *reinterpret_cast<bf16x8*>(&w_); } while (0)

__device__ __forceinline__ int v_st(int k, int c) { const int kk = (k & ~0xC) | ((k & 4) << 1) | ((k & 8) >> 1); return ((kk >> 3) * 4 + (c >> 5)) * 512 + ((kk & 7) * 32 + (c & 31)) * 2; }
__device__ __forceinline__ int v_rd_base(int lane) { return ((lane & 3) << 3) | (((lane >> 2) & 3) << 6) | (((lane >> 4) & 1) << 5) | (((lane >> 5) & 1) << 8); }
constexpr int v_rd_off(int d0, int ks, int half) { return d0 * 512 + ks * 4096 + half * 2048; }
template <int OFF> __device__ __forceinline__ s16x4 tr_read(int vb) { s16x4 r; asm volatile("ds_read_b64_tr_b16 %0, %1 offset:%2" : "=&v"(r) : "v"(vb), "i"(OFF) : "memory"); return r; }
#define PKV(L, H) (bf16x8){L[0], L[1], L[2], L[3], H[0], H[1], H[2], H[3]}
template <int D0> __device__ __forceinline__ void pv_one(f32x16& od, int vb, bf16x8 pa0, bf16x8 pa1, bf16x8 pa2, bf16x8 pa3) {
  const s16x4 l0 = tr_read<v_rd_off(D0, 0, 0)>(vb), h0 = tr_read<v_rd_off(D0, 0, 1)>(vb), l1 = tr_read<v_rd_off(D0, 1, 0)>(vb), h1 = tr_read<v_rd_off(D0, 1, 1)>(vb);
  const s16x4 l2 = tr_read<v_rd_off(D0, 2, 0)>(vb), h2 = tr_read<v_rd_off(D0, 2, 1)>(vb), l3 = tr_read<v_rd_off(D0, 3, 0)>(vb), h3 = tr_read<v_rd_off(D0, 3, 1)>(vb);
  asm volatile("s_waitcnt lgkmcnt(0)" ::: "memory"); SBAR();
  od = __builtin_amdgcn_mfma_f32_32x32x16_bf16(pa0, PKV(l0, h0), od, 0, 0, 0);
  od = __builtin_amdgcn_mfma_f32_32x32x16_bf16(pa1, PKV(l1, h1), od, 0, 0, 0);
  od = __builtin_amdgcn_mfma_f32_32x32x16_bf16(pa2, PKV(l2, h2), od, 0, 0, 0);
  od = __builtin_amdgcn_mfma_f32_32x32x16_bf16(pa3, PKV(l3, h3), od, 0, 0, 0);
}
__device__ __forceinline__ void pv_d0(f32x16* o, int vb, bf16x8 pa0, bf16x8 pa1, bf16x8 pa2, bf16x8 pa3) {
  pv_one<0>(o[0], vb, pa0, pa1, pa2, pa3); pv_one<1>(o[1], vb, pa0, pa1, pa2, pa3); pv_one<2>(o[2], vb, pa0, pa1, pa2, pa3); pv_one<3>(o[3], vb, pa0, pa1, pa2, pa3);
}
template <int D0> __device__ __forceinline__ void pv32_one(f32x16& od, int vb, bf16x8 pa0, bf16x8 pa1) {
  const s16x4 l0 = tr_read<v_rd_off(D0, 0, 0)>(vb), h0 = tr_read<v_rd_off(D0, 0, 1)>(vb), l1 = tr_read<v_rd_off(D0, 1, 0)>(vb), h1 = tr_read<v_rd_off(D0, 1, 1)>(vb);
  asm volatile("s_waitcnt lgkmcnt(0)" ::: "memory"); SBAR();
  od = __builtin_amdgcn_mfma_f32_32x32x16_bf16(pa0, PKV(l0, h0), od, 0, 0, 0);
  od = __builtin_amdgcn_mfma_f32_32x32x16_bf16(pa1, PKV(l1, h1), od, 0, 0, 0);
}
__device__ __forceinline__ void pv32(f32x16* o, int vb, bf16x8 pa0, bf16x8 pa1) {
  pv32_one<0>(o[0], vb, pa0, pa1); pv32_one<1>(o[1], vb, pa0, pa1); pv32_one<2>(o[2], vb, pa0, pa1); pv32_one<3>(o[3], vb, pa0, pa1);
}
__device__ __forceinline__ void stage_v32(const bf16* Vsrc, long rstride, char* vl, int lane) {
  const int c = (lane & 15) * 8, r0 = lane >> 4; bf16x8 v[8];
  const bf16* vp = Vsrc + (long)r0 * rstride + c; asm volatile("" : "+v"(vp));
#pragma unroll
  for (int i = 0; i < 8; ++i) v[i] = ld8(vp + (long)(4 * i) * rstride);
#pragma unroll
  for (int i = 0; i < 8; ++i) *(bf16x8*)(vl + v_st(r0 + 4 * i, c)) = v[i];
  asm volatile("s_waitcnt lgkmcnt(0)" ::: "memory");
}

constexpr int KVBLK = 64;
constexpr size_t SHM_V = KVBLK * 128 * 2, SHM_K = KVBLK * 128 * 2;
constexpr float THR2 = 8.f;
__device__ __forceinline__ void partialSM(f32x16& p0, f32x16& p1, float& m_reg, float& mn, float& alpha) {
  float pmax = p0[0];
#pragma unroll
  for (int r = 1; r < 16; ++r) pmax = fmaxf(pmax, p0[r]);
#pragma unroll
  for (int r = 0; r < 16; ++r) pmax = fmaxf(pmax, p1[r]);
  pmax = swapmax(pmax);
  if (__builtin_expect(__all(pmax - m_reg <= THR2), 1)) { mn = m_reg; alpha = 1.f; }
  else { mn = fmaxf(m_reg, pmax); alpha = __builtin_amdgcn_exp2f(m_reg - mn); m_reg = mn; }
#pragma unroll
  for (int r = 0; r < 16; ++r) { p0[r] -= mn; p1[r] -= mn; }
#pragma unroll
  for (int r = 0; r < 16; ++r) p0[r] = __builtin_amdgcn_exp2f(p0[r]);
}
__device__ __forceinline__ void finishSM(f32x16& p0, f32x16& p1, float alpha, float& l_reg, bf16x8& pa0, bf16x8& pa1, bf16x8& pa2, bf16x8& pa3) {
#pragma unroll
  for (int r = 0; r < 16; ++r) p1[r] = __builtin_amdgcn_exp2f(p1[r]);
  float ps = 0;
#pragma unroll
  for (int r = 0; r < 16; ++r) ps += p0[r];
#pragma unroll
  for (int r = 0; r < 16; ++r) ps += p1[r];
  ps = swapadd(ps);
  l_reg = l_reg * alpha + ps;
  PK4(p0, 0, pa0); PK4(p0, 8, pa1); PK4(p1, 0, pa2); PK4(p1, 8, pa3);
}
__device__ __forceinline__ void qkt64(f32x16& p0, f32x16& p1, const char* Ks, const bf16x8* qr, int r32, int hi, int comp) {
  p0 = f32x16{}; p1 = f32x16{};
#pragma unroll
  for (int d0 = 0; d0 < 4; ++d0) { const int cb = (comp * 64 + d0 * 16 + hi * 8) * 2;
    const bf16x8 b0 = *reinterpret_cast<const bf16x8*>(Ks + KSWZ(r32, cb));
    const bf16x8 b1 = *reinterpret_cast<const bf16x8*>(Ks + KSWZ(32 + r32, cb));
    p0 = __builtin_amdgcn_mfma_f32_32x32x16_bf16(b0, qr[d0], p0, 0, 0, 0);
    p1 = __builtin_amdgcn_mfma_f32_32x32x16_bf16(b1, qr[d0], p1, 0, 0, 0); }
}
__device__ __forceinline__ void datt_unit(const bf16* __restrict__ Qb, const bf16* __restrict__ Kh, const bf16* __restrict__ Vh, bf16* __restrict__ Ob,
                                          const float* __restrict__ subg, float lam, float oscale, int seq, char* lds, int tid) {
  const int wid = tid >> 6, lane = tid & 63, r32 = lane & 31, hi = lane >> 5, comp = wid & 1, rb = wid >> 1;
  char* V_lds = lds; char* K_lds = lds + 2 * SHM_V;
  float* ws = (float*)(lds + 2 * SHM_V + 2 * SHM_K) + wid * 64; float* li_l = ws; float* al_l = ws + 32;
  float m_reg = NEG, l_reg = 0; f32x16 o[4] = {}; bf16x8 qr[4];
  const bf16* Qw = Qb + (long)(rb * 32 + r32) * LD + comp * 64 + hi * 8;
#pragma unroll
  for (int d0 = 0; d0 < 4; ++d0) qr[d0] = ld8(Qw + d0 * 16);
  const int sr = tid >> 4, sc = (tid & 15) * 8, vst0 = v_st(sr, sc), vst1 = v_st(32 + sr, sc);
  const int vb0 = (int)(uintptr_t)V_lds + v_rd_base(lane);
  struct { bf16x8 vs0, vs1, ks0, ks1; } sr_[2];
#define SLOAD(i, k0) do { sr_[i].vs0 = ld8(&Vh[(long)((k0) + sr) * LD + sc]); sr_[i].vs1 = ld8(&Vh[(long)((k0) + 32 + sr) * LD + sc]); \
    sr_[i].ks0 = ld8(&Kh[(long)((k0) + sr) * LD + sc]); sr_[i].ks1 = ld8(&Kh[(long)((k0) + 32 + sr) * LD + sc]); } while (0)
#define SWRITE(b, i) do { *(bf16x8*)(V_lds + (b) * SHM_V + vst0) = sr_[i].vs0; *(bf16x8*)(V_lds + (b) * SHM_V + vst1) = sr_[i].vs1; const int kc = sc * 2; \
    *(bf16x8*)(K_lds + (b) * SHM_K + KSWZ(sr, kc)) = sr_[i].ks0; *(bf16x8*)(K_lds + (b) * SHM_K + KSWZ(32 + sr, kc)) = sr_[i].ks1; } while (0)
#define SWAIT() asm volatile("s_waitcnt vmcnt(4)" ::: "memory")
#define RESC(a) do { if (__any((a) < 1.f)) { if (hi == 0) al_l[r32] = (a); asm volatile("s_waitcnt lgkmcnt(0)" ::: "memory"); \
    _Pragma("unroll") for (int d = 0; d < 4; ++d) _Pragma("unroll") for (int r = 0; r < 16; ++r) o[d][r] *= al_l[crow(r, hi)]; } } while (0)
  f32x16 pA0, pA1, pB0, pB1; float mnA, mnB, alA, alB; bf16x8 pa0, pa1, pa2, pa3; const int NT = seq / KVBLK;
  SLOAD(0, 0); asm volatile("s_waitcnt vmcnt(0)" ::: "memory"); SWRITE(0, 0); __syncthreads();
  qkt64(pA0, pA1, K_lds, qr, r32, hi, comp); partialSM(pA0, pA1, m_reg, mnA, alA);
  SLOAD(1, KVBLK); if (2 < NT) SLOAD(0, 2 * KVBLK);
  SWAIT(); SWRITE(1, 1); __syncthreads();
  for (int j = 1; j + 1 < NT; j += 2) {
    SBAR(); qkt64(pB0, pB1, K_lds + SHM_K, qr, r32, hi, comp);
    finishSM(pA0, pA1, alA, l_reg, pa0, pa1, pa2, pa3); SBAR();
    SLOAD(1, (j + 2) * KVBLK); SBAR();
    pv_d0(o, vb0, pa0, pa1, pa2, pa3); partialSM(pB0, pB1, m_reg, mnB, alB);
    __syncthreads(); SWAIT(); SWRITE(0, 0);
    RESC(alB); __syncthreads();
    SBAR(); qkt64(pA0, pA1, K_lds, qr, r32, hi, comp);
    finishSM(pB0, pB1, alB, l_reg, pa0, pa1, pa2, pa3); SBAR();
    if (j + 3 < NT) SLOAD(0, (j + 3) * KVBLK); SBAR();
    pv_d0(o, vb0 + (int)SHM_V, pa0, pa1, pa2, pa3); partialSM(pA0, pA1, m_reg, mnA, alA);
    __syncthreads(); SWAIT(); SWRITE(1, 1);
    RESC(alA); __syncthreads();
  }
  SBAR(); qkt64(pB0, pB1, K_lds + SHM_K, qr, r32, hi, comp);
  finishSM(pA0, pA1, alA, l_reg, pa0, pa1, pa2, pa3); SBAR();
  pv_d0(o, vb0, pa0, pa1, pa2, pa3); partialSM(pB0, pB1, m_reg, mnB, alB);
  __syncthreads(); RESC(alB);
  finishSM(pB0, pB1, alB, l_reg, pa0, pa1, pa2, pa3); SBAR();
  pv_d0(o, vb0 + (int)SHM_V, pa0, pa1, pa2, pa3);
  if (hi == 0) li_l[r32] = l_reg; asm volatile("s_waitcnt lgkmcnt(0)" ::: "memory");
  float rli[16];
#pragma unroll
  for (int r = 0; r < 16; ++r) rli[r] = __builtin_amdgcn_rcpf(li_l[crow(r, hi)]);
  __syncthreads();
  float* X = (float*)lds + rb * (32 * 128);
  if (comp == 1) {
#pragma unroll
    for (int r = 0; r < 16; ++r)
#pragma unroll
      for (int d0 = 0; d0 < 4; ++d0) X[crow(r, hi) * 128 + d0 * 32 + r32] = o[d0][r] * rli[r];
  }
  __syncthreads();
  if (comp == 0) {
    float g[4];
#pragma unroll
    for (int d0 = 0; d0 < 4; ++d0) g[d0] = *(const ATT_GAS float*)(subg + d0 * 32 + r32) * oscale;
    bf16* ob = Ob + (long)(rb * 32 + 4 * hi) * LD + r32; asm volatile("" : "+v"(ob));
#pragma unroll
    for (int r = 0; r < 16; ++r) {
      float v[4]; float ss = 0.f;
#pragma unroll
      for (int d0 = 0; d0 < 4; ++d0) { v[d0] = o[d0][r] * rli[r] - lam * X[crow(r, hi) * 128 + d0 * 32 + r32]; ss += v[d0] * v[d0]; }
      ss += __shfl_xor(ss, 1); ss += __shfl_xor(ss, 2); ss += __shfl_xor(ss, 4); ss += __shfl_xor(ss, 8); ss += __shfl_xor(ss, 16);
      const float rn = __builtin_amdgcn_rsqf(ss * (1.f / 128.f) + 1e-6f);
      bf16* orow = ob + (long)((r & 3) + 8 * (r >> 2)) * LD;
#pragma unroll
      for (int d0 = 0; d0 < 4; ++d0) st16(orow + d0 * 32, f2bf(v[d0] * rn * g[d0]));
    }
  }
  __syncthreads();
#undef SLOAD
#undef SWRITE
#undef SWAIT
#undef RESC
}

__device__ __forceinline__ void xatt_item(const bf16* __restrict__ Qr, const bf16* __restrict__ Kb, const bf16* __restrict__ Vb, bf16* __restrict__ Or, char* vl, float* wsf, int lane) {
  const int r32 = lane & 31, hi = lane >> 5;
  f32x16 s[8];
#pragma unroll
  for (int kt = 0; kt < 8; ++kt) s[kt] = f32x16{};
#pragma unroll
  for (int dh = 0; dh < 2; ++dh) {
    bf16x8 qx[8];
#pragma unroll
    for (int d0 = 0; d0 < 8; ++d0) qx[d0] = ld8(Qr + (long)r32 * LD + (dh * 8 + d0) * 16 + hi * 8);
#pragma unroll
    for (int kt = 0; kt < 8; ++kt) {
      bf16x8 kf[8];
      const bf16* kp = Kb + (long)(kt * 32 + r32) * LD + dh * 128 + hi * 8; asm volatile("" : "+v"(kp));
#pragma unroll
      for (int d0 = 0; d0 < 8; ++d0) kf[d0] = ld8(kp + d0 * 16);
#pragma unroll
      for (int d0 = 0; d0 < 8; ++d0) s[kt] = __builtin_amdgcn_mfma_f32_32x32x16_bf16(kf[d0], qx[d0], s[kt], 0, 0, 0);
      asm volatile("" ::: "memory");
    }
  }
  float mx = NEG;
#pragma unroll
  for (int kt = 0; kt < 8; ++kt)
#pragma unroll
    for (int r = 0; r < 16; ++r) mx = fmaxf(mx, s[kt][r]);
  mx = swapmax(mx);
  float sum = 0.f;
#pragma unroll
  for (int kt = 0; kt < 8; ++kt)
#pragma unroll
    for (int r = 0; r < 16; ++r) { s[kt][r] = __builtin_amdgcn_exp2f(s[kt][r] - mx); sum += s[kt][r]; }
  sum = swapadd(sum);
  bf16x8 pa[16];
#pragma unroll
  for (int kt = 0; kt < 8; ++kt) { PK4(s[kt], 0, pa[2 * kt]); PK4(s[kt], 8, pa[2 * kt + 1]); }
  if (hi == 0) wsf[r32] = sum; asm volatile("s_waitcnt lgkmcnt(0)" ::: "memory");
  const int vb = (int)(uintptr_t)vl + v_rd_base(lane);
#pragma unroll
  for (int hf = 0; hf < 2; ++hf) {
    f32x16 o[4] = {};
#pragma unroll
    for (int kt = 0; kt < 8; ++kt) {
      stage_v32(Vb + (long)(kt * 32) * LD + hf * 128, LD, vl, lane);
      pv32(o, vb, pa[2 * kt], pa[2 * kt + 1]);
    }
    bf16* ob = Or + (long)(4 * hi) * LD + hf * 128 + r32; asm volatile("" : "+v"(ob));
#pragma unroll
    for (int r = 0; r < 16; ++r) { bf16* orow = ob + (long)((r & 3) + 8 * (r >> 2)) * LD; const float rl = __builtin_amdgcn_rcpf(wsf[crow(r, hi)]);
#pragma unroll
      for (int d0 = 0; d0 < 4; ++d0) st16(orow + d0 * 32, f2bf(o[d0][r] * rl)); }
  }
}

template <bool LAST>
__device__ __forceinline__ void dil_item(int dil, long tok0  , int jb, int Lseq, const bf16* __restrict__ Qh, const bf16* __restrict__ Kh, const bf16* __restrict__ Vh,
                                         bf16* Oh, float* Lh, const bf16* O1h, const float* L0h, const float* L1h, char* vl, float* wsf, int lane) {
  const int r32 = lane & 31, hi = lane >> 5;
  const long rstride = (long)dil * LD;
  bf16x8 qr[8];
  { const bf16* Qw = Qh + (tok0 + (long)dil * (32 * jb + r32)) * LD + hi * 8;
#pragma unroll
    for (int d0 = 0; d0 < 8; ++d0) qr[d0] = ld8(Qw + d0 * 16); }
  f32x16 s[5];
#pragma unroll
  for (int kt = 0; kt < 5; ++kt) {
    const int jk0 = 32 * jb - 64 + 32 * kt; const bool valid = (jk0 >= 0) && (jk0 < Lseq);
    s[kt] = f32x16{};
    if (valid) {
      const bf16* Kw = Kh + (tok0 + (long)dil * (jk0 + r32)) * LD + hi * 8; asm volatile("" : "+v"(Kw));
#pragma unroll
      for (int d0 = 0; d0 < 8; ++d0) { const bf16x8 kf = ld8(Kw + d0 * 16); s[kt] = __builtin_amdgcn_mfma_f32_32x32x16_bf16(kf, qr[d0], s[kt], 0, 0, 0); }
      if (kt == 0) {
#pragma unroll
        for (int r = 0; r < 16; ++r) if (crow(r, hi) < r32) s[kt][r] = NEG; }
      if (kt == 4) {
#pragma unroll
        for (int r = 0; r < 16; ++r) if (crow(r, hi) > r32) s[kt][r] = NEG; }
    } else {
#pragma unroll
      for (int r = 0; r < 16; ++r) s[kt][r] = NEG;
    }
  }
  float mx = NEG;
#pragma unroll
  for (int kt = 0; kt < 5; ++kt)
#pragma unroll
    for (int r = 0; r < 16; ++r) mx = fmaxf(mx, s[kt][r]);
  mx = swapmax(mx);
  float sum = 0.f;
#pragma unroll
  for (int kt = 0; kt < 5; ++kt)
#pragma unroll
    for (int r = 0; r < 16; ++r) { s[kt][r] = __builtin_amdgcn_exp2f(s[kt][r] - mx); sum += s[kt][r]; }
  sum = swapadd(sum);
  bf16x8 pa[10];
#pragma unroll
  for (int kt = 0; kt < 5; ++kt) { PK4(s[kt], 0, pa[2 * kt]); PK4(s[kt], 8, pa[2 * kt + 1]); }
  const float lse = mx + __builtin_amdgcn_logf(sum);
  if (hi == 0) { wsf[r32] = sum; wsf[32 + r32] = lse; } asm volatile("s_waitcnt lgkmcnt(0)" ::: "memory");
  const int vb = (int)(uintptr_t)vl + v_rd_base(lane);
  f32x16 o[4] = {};
#pragma unroll
  for (int kt = 0; kt < 5; ++kt) {
    const int jk0 = 32 * jb - 64 + 32 * kt; const bool valid = (jk0 >= 0) && (jk0 < Lseq);
    if (valid) {
      stage_v32(Vh + (tok0 + (long)dil * jk0) * LD, rstride, vl, lane);
      pv32(o, vb, pa[2 * kt], pa[2 * kt + 1]);
    }
  }
  long tokb = tok0 + (long)dil * (32 * jb + 4 * hi); asm volatile("" : "+v"(tokb));
#pragma unroll
  for (int r = 0; r < 16; ++r) {
    const int qi = crow(r, hi); const long tok = tokb + (long)dil * ((r & 3) + 8 * (r >> 2));
    const float rl = __builtin_amdgcn_rcpf(wsf[qi]);
    if (!LAST) {
#pragma unroll
      for (int d0 = 0; d0 < 4; ++d0) st16(Oh + tok * LD + d0 * 32 + r32, f2bf(o[d0][r] * rl));
    } else {
      const float a2 = wsf[32 + qi], a0 = *(const ATT_GAS float*)(L0h + tok * 8), a1 = *(const ATT_GAS float*)(L1h + tok * 8);
      const float M = fmaxf(fmaxf(a0, a1), a2);
      const float w0 = __builtin_amdgcn_exp2f(a0 - M), w1 = __builtin_amdgcn_exp2f(a1 - M), w2 = __builtin_amdgcn_exp2f(a2 - M);
      const float rw = __builtin_amdgcn_rcpf(w0 + w1 + w2);
#pragma unroll
      for (int d0 = 0; d0 < 4; ++d0) { const long idx = tok * LD + d0 * 32 + r32;
        const float v = (w0 * bf2f(*(const ATT_GAS bf16*)(Oh + idx)) + w1 * bf2f(*(const ATT_GAS bf16*)(O1h + idx)) + w2 * (o[d0][r] * rl)) * rw; st16(Oh + idx, f2bf(v)); }
    }
  }
  if (!LAST) { if (hi == 0) *(ATT_GAS float*)(Lh + (tok0 + (long)dil * (32 * jb + r32)) * 8) = lse; }
}
#undef PK4
#undef PKV
}
#define GAS __attribute__((address_space(1)))
#define LAS __attribute__((address_space(3)))
typedef unsigned short bf16;
typedef unsigned v4u __attribute__((ext_vector_type(4)));
typedef float f32x4 __attribute__((ext_vector_type(4)));
typedef short bf16x8 __attribute__((ext_vector_type(8)));
typedef GAS unsigned gu32;
typedef GAS unsigned long long gu64;
#define RLX_AGENT __ATOMIC_RELAXED, __HIP_MEMORY_SCOPE_AGENT
#define LDS_WAIT() asm volatile("s_waitcnt lgkmcnt(0)" ::: "memory")
#define VM_WAIT() asm volatile("s_waitcnt vmcnt(0)" ::: "memory")
__device__ __forceinline__ unsigned long long rt() { return __builtin_amdgcn_s_memrealtime(); }
__device__ __forceinline__ unsigned f2bf(float f) { unsigned u = __builtin_bit_cast(unsigned, f); return (u + 0x7fffu + ((u >> 16) & 1u)) >> 16; }
__device__ __forceinline__ unsigned pk2(float lo, float hi) { return f2bf(lo) | (f2bf(hi) << 16); }

#define XB_TMO      128
#define XB_XCNT(j)  (256  + 64 * (j))
#define XB_XSUB(j)  (1280 + 64 * (j))
#define XB_XGEN(j)  (2304 + 64 * (j))
#define XB_TOP      3328
#define XB_TOPGEN   3392
#define XCD_BAR_WORDS 3456
#define XB_SPIN_CAP (1u << 18)

__device__ __forceinline__ unsigned xb_ld(unsigned* p)              { return __hip_atomic_load(p, __ATOMIC_RELAXED, __HIP_MEMORY_SCOPE_AGENT); }
__device__ __forceinline__ unsigned xb_add(unsigned* p, unsigned v) { return __hip_atomic_fetch_add(p, v, __ATOMIC_RELAXED, __HIP_MEMORY_SCOPE_AGENT); }
__device__ __forceinline__ unsigned xb_xcc_id() { return (unsigned)__builtin_amdgcn_s_getreg((3 << 11) | 20) & 0xFu; }
#define XB_SPIN(cond, bar) do { unsigned _sp = 0; while (cond) { __builtin_amdgcn_s_sleep(1); \
    if ((++_sp & 255u) == 0u) { if (xb_ld(&(bar)[XB_TMO])) break; if (_sp > XB_SPIN_CAP) { atomicAdd(&(bar)[XB_TMO], 1u); break; } } } } while (0)

struct XcdBarrier {
    unsigned* bar; unsigned x;
    volatile LAS unsigned* st;
};

__device__ __forceinline__ XcdBarrier xcd_barrier_post(unsigned* bar, volatile LAS unsigned* st) {
    XcdBarrier b; b.bar = bar; b.x = xb_xcc_id(); b.st = st;
    if (threadIdx.x == 0) (void)xb_add(&bar[XB_XCNT(b.x)], 1u);
    return b;
}
__device__ __forceinline__ void xcd_barrier_complete(unsigned* bar, unsigned x, unsigned& nloc, unsigned& nx) {
    const unsigned G = gridDim.x * gridDim.y * gridDim.z;
    unsigned sum, cnt, mine, sp = 0u;
    for (;;) {
        sum = 0u; cnt = 0u; mine = 0u;
#pragma unroll
        for (unsigned j = 0; j < 16; ++j) { const unsigned c = xb_ld(&bar[XB_XCNT(j)]); sum += c; cnt += (c > 0u) ? 1u : 0u; mine = (j == x) ? c : mine; }
        if (sum == G) break;
        __builtin_amdgcn_s_sleep(1);
        if ((++sp & 255u) == 0u) { if (xb_ld(&bar[XB_TMO])) break; if (sp > XB_SPIN_CAP) { atomicAdd(&bar[XB_TMO], 1u); break; } }
    }
    nloc = mine > 0u ? mine : 1u; nx = cnt > 0u ? cnt : 1u;
}

__device__ __forceinline__ void xcd_barrier(const XcdBarrier& b) {
    asm volatile("s_waitcnt vmcnt(0)" ::: "memory");
    __syncthreads();
    if (threadIdx.x == 0) {
        unsigned* bar = b.bar;
        __builtin_amdgcn_s_waitcnt(0);
        unsigned nloc = b.st[0], nx = b.st[1];
        if (nloc == 0u) { xcd_barrier_complete(bar, b.x, nloc, nx); b.st[0] = nloc; b.st[1] = nx; }
        const unsigned old = xb_add(&bar[XB_XSUB(b.x)], 1u);
        const unsigned gen = old / nloc;
        if (old + 1u == (gen + 1u) * nloc) {
            __builtin_amdgcn_fence(__ATOMIC_RELEASE, "agent");
            asm volatile("s_waitcnt vmcnt(0)" ::: "memory");
            const unsigned og = xb_add(&bar[XB_TOP], 1u);
            const unsigned tg = og / nx;
            if (og + 1u == (tg + 1u) * nx) xb_add(&bar[XB_TOPGEN], 1u);
            else XB_SPIN(xb_ld(&bar[XB_TOPGEN]) == tg, bar);
            __builtin_amdgcn_fence(__ATOMIC_ACQUIRE, "agent");
            xb_add(&bar[XB_XGEN(b.x)], 1u);
            asm volatile("s_waitcnt vmcnt(0)" ::: "memory");
        } else {
            XB_SPIN(xb_ld(&bar[XB_XGEN(b.x)]) == gen, bar);
            __builtin_amdgcn_fence(__ATOMIC_ACQUIRE, "agent");
            asm volatile("s_waitcnt vmcnt(0)" ::: "memory");
        }
    }
    __syncthreads();
}

constexpr int NWAVES = 8;
constexpr int BATCH = 2, SEQ = 8192, D = 1024, FF = 4096, MEMLEN = 256;
constexpr int M = BATCH * SEQ;
constexpr float EPS = 1e-6f;
constexpr float LOG2E = 1.4426950408889634f;
constexpr size_t MiB = 1u << 20;
constexpr size_t WS_CTL = 0, CTL_ZERO_BYTES = 1 * MiB;
constexpr size_t WS_INV64 = 1 * MiB, WS_INV128 = 1 * MiB + 256;
constexpr size_t WS_LSE0 = 2 * MiB, WS_LSE1 = 2 * MiB + 512 * 1024;
constexpr size_t WS_KX = 3 * MiB;
constexpr size_t WS_MN = 7 * MiB;
constexpr size_t WS_W = 10 * MiB;
constexpr size_t W_QKV = 0, W_O = 18 * MiB, W_XQ = 20 * MiB, W_XO = 22 * MiB, W_UP = 24 * MiB, W_DN = 32 * MiB, W_XKV0 = 40 * MiB, W_XKV1 = 6 * MiB;
constexpr size_t WS_R1 = 54 * MiB, WS_R2 = 86 * MiB, WS_R3 = 118 * MiB, WS_R4 = 150 * MiB, WS_R5 = 182 * MiB, WS_R6 = 214 * MiB, WS_END = 246 * MiB;
constexpr int CW_BAR = 4096;
constexpr int RING_BYTES = 131072, LDSCTL_OFF = RING_BYTES, MISC_OFF = LDSCTL_OFF + 320, ARG_OFF = LDSCTL_OFF + 1024, LDS_BYTES = 147456;
__device__ __forceinline__ unsigned long long ldarg(LAS unsigned char* l, int i) { volatile LAS unsigned* p = (volatile LAS unsigned*)(l + ARG_OFF) + 2 * i;
    const unsigned lo = __builtin_amdgcn_readfirstlane(p[0]), hi = __builtin_amdgcn_readfirstlane(p[1]); return ((unsigned long long)hi << 32) | lo; }
#define ARGF(i) ((const float*)ldarg(ldsl, (i)))
#define ARG_OUT ((float*)ldarg(ldsl, 21))
#define ARG_WS ((unsigned char*)ldarg(ldsl, 22))

__device__ __forceinline__ float wave_sum(float v) {
#pragma unroll
    for (int o = 1; o < 64; o <<= 1) v += __shfl_xor(v, o);
    return v;
}
__device__ __forceinline__ int src_col(int mode, int n) {
    if (mode == 1) { if (n >= 2048) return n; const int o = n & 63; return (n & ~63) + (o >> 1) + 32 * (o & 1); }
    if (mode == 2) { const int g = n / 3072, t = (n % 3072) / 1024, c = n % 1024, o = c & 127; const int d = (t < 2) ? ((o >> 1) + 64 * (o & 1)) : o; return t * 3072 + g * 1024 + (c & ~127) + d; }
    return n;
}
__device__ __forceinline__ void transpose_item(const float* W, int K, int N, bf16* WT, int mode, LAS float* scr, int item, int lane) {
    const int nblk = N / 32, kb = item / nblk, nb = item % nblk, k0 = 64 * kb, n0 = 32 * nb;
    const int sc = src_col(mode, n0 + (lane & 31));
#pragma unroll 8
    for (int i = 0; i < 32; ++i) { const int kk = 2 * i + (lane >> 5); scr[kk * 33 + (lane & 31)] = W[(size_t)(k0 + kk) * N + sc]; }
    LDS_WAIT(); asm volatile("" ::: "memory");
    const int c = lane & 7;
#pragma unroll
    for (int j = 0; j < 4; ++j) { const int n = (lane >> 3) + 8 * j; const LAS float* s = scr + (8 * c) * 33 + n;
        v4u o; o.x = pk2(s[0 * 33], s[1 * 33]); o.y = pk2(s[2 * 33], s[3 * 33]); o.z = pk2(s[4 * 33], s[5 * 33]); o.w = pk2(s[6 * 33], s[7 * 33]);
        *(GAS v4u*)(WT + (size_t)(n0 + n) * K + k0 + 8 * c) = o; }
    LDS_WAIT(); asm volatile("" ::: "memory");
}
__device__ __forceinline__ void rms_row_to_bf16(const float* xrow, const float* g, bf16* orow, int lane) {
    const f32x4* xr = (const f32x4*)xrow + lane; const f32x4* gr = (const f32x4*)g + lane;
    f32x4 v[4]; float s = 0.f;
#pragma unroll
    for (int j = 0; j < 4; ++j) { v[j] = xr[64 * j]; s += (v[j].x * v[j].x + v[j].y * v[j].y) + (v[j].z * v[j].z + v[j].w * v[j].w); }
    const float rs = __builtin_amdgcn_rsqf(wave_sum(s) * (1.f / D) + EPS);
    unsigned long long* o8 = (unsigned long long*)orow + lane;
#pragma unroll
    for (int j = 0; j < 4; ++j) { const f32x4 gg = gr[64 * j];
        o8[64 * j] = (unsigned long long)pk2(v[j].x * rs * gg.x, v[j].y * rs * gg.y) | ((unsigned long long)pk2(v[j].z * rs * gg.z, v[j].w * rs * gg.w) << 32); }
}
__device__ __forceinline__ void res_row(const float* yrow, const float* xold, float* xout, const float* g1, const float* g2, bf16* xn, int lane) {
    const f32x4* yr = (const f32x4*)yrow + lane; const f32x4* xr = (const f32x4*)xold + lane; const f32x4* g1r = (const f32x4*)g1 + lane;
    f32x4 y[4], x[4]; float s = 0.f;
#pragma unroll
    for (int j = 0; j < 4; ++j) { y[j] = yr[64 * j]; x[j] = xr[64 * j]; s += (y[j].x * y[j].x + y[j].y * y[j].y) + (y[j].z * y[j].z + y[j].w * y[j].w); }
    const float rs = __builtin_amdgcn_rsqf(wave_sum(s) * (1.f / D) + EPS);
    float s2 = 0.f;
#pragma unroll
    for (int j = 0; j < 4; ++j) { const f32x4 gg = g1r[64 * j]; x[j] = x[j] + y[j] * rs * gg; s2 += (x[j].x * x[j].x + x[j].y * x[j].y) + (x[j].z * x[j].z + x[j].w * x[j].w); }
    f32x4* xo = (f32x4*)xout + lane;
#pragma unroll
    for (int j = 0; j < 4; ++j) xo[64 * j] = x[j];
    if (xn) {
        const float rs2 = __builtin_amdgcn_rsqf(wave_sum(s2) * (1.f / D) + EPS);
        const f32x4* g2r = (const f32x4*)g2 + lane; unsigned long long* o8 = (unsigned long long*)xn + lane;
#pragma unroll
        for (int j = 0; j < 4; ++j) { const f32x4 gg = g2r[64 * j];
            o8[64 * j] = (unsigned long long)pk2(x[j].x * rs2 * gg.x, x[j].y * rs2 * gg.y) | ((unsigned long long)pk2(x[j].z * rs2 * gg.z, x[j].w * rs2 * gg.w) << 32); }
    }
}

#ifndef MK_N_LAUNCHES
#define MK_N_LAUNCHES 0
#endif
#ifndef MK_LAST_PHASE
#define MK_LAST_PHASE 26
#endif
constexpr int NPH = 27;
#ifndef EN_CONV
#define EN_CONV 1
#endif
#ifndef EN_DATT
#define EN_DATT 1
#endif
#ifndef EN_XATT
#define EN_XATT 1
#endif
#ifndef EN_DIL
#define EN_DIL 1
#endif
#ifndef EN_GEMM
#define EN_GEMM 1
#endif
#ifndef EN_ROWS
#define EN_ROWS 1
#endif
struct Args { const void* in[21]; float* out; unsigned char* ws; int ph_lo, ph_hi; };

struct GD { const bf16* A; const bf16* Bt; int Mr, N, K; int f32out; float* C; bf16* O; int ldc; int split_cols; size_t split_stride; float scale0; int act; int rope_dh; const float* inv; };

__global__ void __launch_bounds__(NWAVES * 64, 2) skel_fwd(Args args) {
    extern __shared__ __attribute__((aligned(16))) unsigned char lds[];
    LAS unsigned char* ldsl = (LAS unsigned char*)lds;
    {
        const int tid = threadIdx.x;
        for (int u = tid; u < (LDS_BYTES - LDSCTL_OFF) / 4; u += NWAVES * 64) ((LAS unsigned*)(ldsl + LDSCTL_OFF))[u] = 0u;
        __syncthreads();
        if (tid < 23) { const unsigned long long v = (tid < 21) ? (unsigned long long)args.in[tid] : (tid == 21 ? (unsigned long long)args.out : (unsigned long long)args.ws);
            ((LAS unsigned long long*)(ldsl + ARG_OFF))[tid] = v; }
        __syncthreads();
    }
    const int lo = args.ph_lo, hi = args.ph_hi;
    XcdBarrier bar; bar.bar = (unsigned*)(ARG_WS + WS_CTL) + CW_BAR; bar.x = 0; bar.st = nullptr;
    if (hi - lo > 1) bar = xcd_barrier_post((unsigned*)(ARG_WS + WS_CTL) + CW_BAR, (volatile LAS unsigned*)(ldsl + MISC_OFF) + 8);

#pragma nounroll
    for (int ph = lo; ph < hi; ++ph) {
        int tid_ = threadIdx.x; asm volatile("" : "+v"(tid_));
        const int tid = tid_, lane = tid & 63, wave = __builtin_amdgcn_readfirstlane(tid >> 6);
        int bx_ = blockIdx.x; asm volatile("" : "+s"(bx_));
        const int G = gridDim.x; const int bx = bx_; const int vcu = (G % 8 == 0) ? (bx % 8) * (G / 8) + bx / 8 : bx;
        const int gw = vcu * NWAVES + wave, NGW = G * NWAVES;
        const int layer = ph >= 12 ? 1 : 0;
        const int lp = ph >= 12 ? (ph >= 18 ? ph - 15 : -1) : ph;
        if (EN_CONV && (ph == 0 || ph == 11)) {
            LAS float* scr = (LAS float*)(ldsl + wave * 16384);
            const int L = (ph == 0) ? 0 : 1;
            unsigned char* Wb = ARG_WS + WS_W;
            const float* wqkv = L ? ARGF(9) : ARGF(5); const float* wo = L ? ARGF(10) : ARGF(8);
            const float* wxq = ARGF(13) + (size_t)L * D * D; const float* wxo = ARGF(15) + (size_t)L * D * D;
            const float* wup = ARGF(18) + (size_t)L * D * FF; const float* wdn = ARGF(19) + (size_t)L * FF * D;
            const float* wxkv = ARGF(14);
            const int NQ = L ? 9216 : 3072;
            const int I_QKV = (D / 64) * (NQ / 32), I_SQ = (D / 64) * (D / 32), I_UP = (D / 64) * (FF / 32), I_DN = (FF / 64) * (D / 32), I_KV = (D / 64) * (2048 / 32);
            const int NIT = I_QKV + 3 * I_SQ + I_UP + I_DN + (L ? 0 : 2 * I_KV);
            for (int it = gw; it < NIT; it += NGW) {
                int r = it;
                if (r < I_QKV) { transpose_item(wqkv, D, NQ, (bf16*)(Wb + W_QKV), L ? 2 : 1, scr, r, lane); continue; } r -= I_QKV;
                if (r < I_SQ) { transpose_item(wo, D, D, (bf16*)(Wb + W_O), 0, scr, r, lane); continue; } r -= I_SQ;
                if (r < I_SQ) { transpose_item(wxq, D, D, (bf16*)(Wb + W_XQ), 0, scr, r, lane); continue; } r -= I_SQ;
                if (r < I_SQ) { transpose_item(wxo, D, D, (bf16*)(Wb + W_XO), 0, scr, r, lane); continue; } r -= I_SQ;
                if (r < I_UP) { transpose_item(wup, D, FF, (bf16*)(Wb + W_UP), 0, scr, r, lane); continue; } r -= I_UP;
                if (r < I_DN) { transpose_item(wdn, FF, D, (bf16*)(Wb + W_DN), 0, scr, r, lane); continue; } r -= I_DN;
                if (r < I_KV) { transpose_item(wxkv, D, 2048, (bf16*)(Wb + W_XKV0), 0, scr, r, lane); continue; } r -= I_KV;
                transpose_item(wxkv + (size_t)D * 2048, D, 2048, (bf16*)(Wb + W_XKV1), 0, scr, r, lane);
            }
        }
        if (EN_CONV && ph == 0) {
            unsigned char* ws = ARG_WS;
            if (bx == 0 && wave == 0) {
                float* inv64 = (float*)(ws + WS_INV64); float* inv128 = (float*)(ws + WS_INV128);
                { double v = 1.0; for (int k = 0; k < (lane & 31); ++k) v *= 0.7498942093324558; if (lane < 32) inv64[lane] = (float)v; }
                { double v = 1.0; for (int k = 0; k < lane; ++k) v *= 0.8659643233600653; inv128[lane] = (float)v; }
            }
            const float* x_in = ARGF(0); const float* g0 = ARGF(3); bf16* R1 = (bf16*)(ws + WS_R1);
            for (int m = gw; m < M; m += NGW) rms_row_to_bf16(x_in + (size_t)m * D, g0, R1 + (size_t)m * D, lane);
            const float* mg = ARGF(12); const float* mem = ARGF(1);
            for (int m = gw; m < 2 * BATCH * MEMLEN; m += NGW) { const int l = m / (BATCH * MEMLEN), r = m % (BATCH * MEMLEN);
                rms_row_to_bf16(mem + (size_t)r * D, mg + (size_t)l * D, (bf16*)(ws + WS_MN + (size_t)l * MiB) + (size_t)r * D, lane); }
        }
        {
            int nsub = 0;
            if (ph == 1) nsub = 3;
            else if (ph == 3 || ph == 5 || ph == 7 || ph == 9 || ph == 10 || ph == 12 || ph == 14 || ph == 16 || ph == 18 || ph == 20 || ph == 22 || ph == 24 || ph == 25) nsub = 1;
#pragma nounroll
            for (int sub = 0; EN_GEMM && sub < nsub; ++sub) {
                unsigned char* ws = ARG_WS; unsigned char* Wb = ws + WS_W;
                bf16* R1 = (bf16*)(ws + WS_R1); bf16* R2 = (bf16*)(ws + WS_R2); bf16* R5 = (bf16*)(ws + WS_R5);
                GD g; g.Mr = M; g.N = D; g.K = D; g.f32out = 0; g.C = nullptr; g.O = nullptr; g.ldc = D; g.split_cols = 0; g.split_stride = 0; g.scale0 = 1.f; g.act = 0; g.rope_dh = 0; g.inv = nullptr; g.A = R1; g.Bt = (const bf16*)Wb;
                if (ph == 1 && sub == 0) { g.A = R1; g.Bt = (const bf16*)(Wb + W_QKV); g.N = 3072; g.O = R2; g.split_cols = 1024; g.split_stride = (size_t)(WS_R3 - WS_R2) / 2; g.scale0 = 0.125f * LOG2E; g.rope_dh = 64; g.inv = (const float*)(ws + WS_INV64); }
                else if (ph == 1) { const int l = sub - 1; g.A = (const bf16*)(ws + WS_MN + (size_t)l * MiB); g.Bt = (const bf16*)(Wb + (l ? W_XKV1 : W_XKV0)); g.Mr = BATCH * MEMLEN; g.N = 2048;
                    g.O = (bf16*)(ws + WS_KX + (size_t)l * 2 * MiB); g.split_cols = 1024; g.split_stride = (size_t)MiB / 2; }
                else if (ph == 12 || ph == 14 || ph == 16) { const int gq = (ph - 12) / 2; g.A = R1; g.Bt = (const bf16*)(Wb + W_QKV) + (size_t)gq * 3072 * D; g.N = 3072; g.O = R2; g.split_cols = 1024; g.split_stride = (size_t)(WS_R3 - WS_R2) / 2;
                    g.scale0 = 0.08838834764831845f * LOG2E; g.rope_dh = 128; g.inv = (const float*)(ws + WS_INV128); }
                else if (lp == 3) { g.A = R5; g.Bt = (const bf16*)(Wb + W_O); g.f32out = 1; g.C = (float*)R2; }
                else if (lp == 5) { g.A = R1; g.Bt = (const bf16*)(Wb + W_XQ); g.O = R2; g.scale0 = 0.0625f * LOG2E; }
                else if (lp == 7) { g.A = R5; g.Bt = (const bf16*)(Wb + W_XO); g.f32out = 1; g.C = (float*)R2; }
                else if (lp == 9) { g.A = R5; g.Bt = (const bf16*)(Wb + W_UP); g.N = FF; g.O = R1; g.ldc = FF; g.act = 1; }
                else if (lp == 10) { g.A = R1; g.Bt = (const bf16*)(Wb + W_DN); g.K = FF; g.f32out = 1; g.C = (float*)R5; }
                pg8::Gemm gg{g.A, g.Bt, g.Mr, g.N, g.K}; pg8::StaticOrder S; S.init(g.Mr, g.N, G, bx);
                if (g.f32out) { pg8::EpiF32 E{g.C, g.ldc}; pg8::gemm_phase<pg8::EpiF32, pg8::StaticOrder, true, true>(ldsl, gg, S, E); }
                else { pg8::EpiBf16G E{g.O, g.ldc, g.split_cols, g.split_stride, g.scale0, g.act, g.rope_dh, (const int*)ldarg(ldsl, 2), g.inv};
                    pg8::gemm_phase<pg8::EpiBf16G, pg8::StaticOrder, true, true>(ldsl, gg, S, E); }
            }
        }
        if (EN_DATT && ph == 2) {
            const float* lamp = ARGF(6);
            const float sa = wave_sum(lamp[lane] * lamp[64 + lane]), sb = wave_sum(lamp[128 + lane] * lamp[192 + lane]);
            const float lam = __expf(sa) - __expf(sb) + 0.2f;
#pragma nounroll
            for (int i = 0; i < 4; ++i) {
                const int bh = vcu >> 4, qb = (vcu & 15) * 4 + i; if (bh >= 16) break;
                const int b = bh >> 3, h = bh & 7; const size_t rowbase = (size_t)b * SEQ;
                unsigned char* ws = ARG_WS; const float* subg = ARGF(7);
                const bf16* R2 = (const bf16*)(ws + WS_R2); const bf16* R3 = (const bf16*)(ws + WS_R3); const bf16* R4 = (const bf16*)(ws + WS_R4); bf16* R5 = (bf16*)(ws + WS_R5);
                att::datt_unit(R2 + (rowbase + (size_t)qb * 128) * D + h * 128, R3 + rowbase * D + h * 128, R4 + rowbase * D + h * 128, R5 + (rowbase + (size_t)qb * 128) * D + h * 128,
                               subg, lam, 0.8f, SEQ, (char*)lds, tid);
            }
        }
        if (EN_ROWS && (ph == 4 || ph == 8 || ph == 11 || ph == 19 || ph == 23 || ph == 26)) {
            unsigned char* ws = ARG_WS; float* out = ARG_OUT;
            const int k = (lp == 4) ? 0 : (lp == 8 ? 1 : 2);
            const float* Y = (k == 2) ? (const float*)(ws + WS_R5) : (const float*)(ws + WS_R2);
            const float* g1 = (k == 0 ? ARGF(4) : (k == 1 ? ARGF(16) : ARGF(20))) + (size_t)layer * D;
            const float* g2 = (k == 0) ? ARGF(11) + (size_t)layer * D : (k == 1 ? ARGF(17) + (size_t)layer * D : ARGF(3) + D);
            bf16* xn = (k == 1) ? (bf16*)(ws + WS_R5) : (bf16*)(ws + WS_R1); if (ph == 26) xn = nullptr;
            const float* xold = (ph == 4) ? ARGF(0) : (const float*)out;
            for (int m = gw; m < M; m += NGW) res_row(Y + (size_t)m * D, xold + (size_t)m * D, out + (size_t)m * D, g1, g2, xn ? xn + (size_t)m * D : nullptr, lane);
        }
        if (EN_XATT && (ph == 6 || ph == 21)) {
            unsigned char* ws = ARG_WS;
            const bf16* Kx = (const bf16*)(ws + WS_KX + (size_t)layer * 2 * MiB); const bf16* Vx = Kx + (size_t)MiB / 2;
            const bf16* R2 = (const bf16*)(ws + WS_R2); bf16* R5 = (bf16*)(ws + WS_R5);
            char* vl = (char*)lds + wave * 8192; float* wsf = (float*)((char*)lds + 65536) + wave * 64;
#pragma nounroll
            for (int u = vcu; u < (M / 256) * 4; u += G) {
                const int pm = u >> 2, head = u & 3; const size_t m0 = (size_t)pm * 256 + wave * 32; const int b = (int)(m0 / SEQ);
                att::xatt_item(R2 + m0 * D + head * 256, Kx + (size_t)b * MEMLEN * D + head * 256, Vx + (size_t)b * MEMLEN * D + head * 256, R5 + m0 * D + head * 256, vl, wsf, lane);
            }
        }
        if (EN_DIL && (ph == 13 || ph == 15 || ph == 17)) {
            unsigned char* ws = ARG_WS;
            const bf16* R2 = (const bf16*)(ws + WS_R2); const bf16* R3 = (const bf16*)(ws + WS_R3); const bf16* R4 = (const bf16*)(ws + WS_R4); bf16* R5 = (bf16*)(ws + WS_R5); bf16* R6 = (bf16*)(ws + WS_R6);
            float* LSE0 = (float*)(ws + WS_LSE0); float* LSE1 = (float*)(ws + WS_LSE1);
            const int gq = (ph - 13) / 2; const int dil = gq == 0 ? 1 : (gq == 1 ? 4 : 16); const int Lseq = SEQ / dil, nblk = Lseq / 32;
            char* vl = (char*)lds + wave * 8192; float* wsf = (float*)((char*)lds + 65536) + wave * 64;
#pragma nounroll
            for (int it = 0; it < 2; ++it) {
                const int idx = vcu * 16 + wave * 2 + it;
                if (idx < 4096) {
                const int jb = idx % nblk, t1 = idx / nblk, h = t1 & 7, br = t1 >> 3, b = br / dil, r = br % dil;
                const long tok0 = (long)b * SEQ + r; const int hc = h * 128;
                if (gq == 0) att::dil_item<false>(dil, tok0, jb, Lseq, R2 + hc, R3 + hc, R4 + hc, R5 + hc, LSE0 + h, nullptr, nullptr, nullptr, vl, wsf, lane);
                else if (gq == 1) att::dil_item<false>(dil, tok0, jb, Lseq, R2 + hc, R3 + hc, R4 + hc, R6 + hc, LSE1 + h, nullptr, nullptr, nullptr, vl, wsf, lane);
                else att::dil_item<true>(dil, tok0, jb, Lseq, R2 + hc, R3 + hc, R4 + hc, R5 + hc, nullptr, R6 + hc, LSE0 + h, LSE1 + h, vl, wsf, lane);
                }
            }
        }
        if (ph + 1 < hi) xcd_barrier(bar);
    }
}

extern "C" void kernel_launch(void* const* d_in, const int* in_sizes, int n_in, void* d_out, int out_size, void* d_ws, size_t ws_size, hipStream_t stream) {
    static int grid = 0;
    if (grid == 0) {
        if (n_in != 21 || in_sizes[0] != M * D || out_size != M * D || ws_size < WS_END) { fprintf(stderr, "kernel_launch: unexpected shapes (n_in %d, in0 %d, out %d, ws %zu); nothing launched\n", n_in, n_in > 0 ? in_sizes[0] : -1, out_size, ws_size); grid = -1; return; }
        int dev = 0, cus = 0;
        if (hipGetDevice(&dev) != hipSuccess || hipDeviceGetAttribute(&cus, hipDeviceAttributeMultiprocessorCount, dev) != hipSuccess) { grid = -1; return; }
        if (hipFuncSetAttribute((const void*)skel_fwd, hipFuncAttributeMaxDynamicSharedMemorySize, LDS_BYTES) != hipSuccess) { fprintf(stderr, "kernel_launch: hipFuncSetAttribute failed\n"); grid = -1; return; }
        (void)hipGetLastError();
        grid = cus;
        if (grid != 256) fprintf(stderr, "kernel_launch: %d CUs (built for 256)\n", grid);
    }
    if (grid < 0) return;
    (void)hipMemsetAsync((char*)d_ws + WS_CTL, 0, CTL_ZERO_BYTES, stream);
    Args a{};
    for (int i = 0; i < 21; ++i) a.in[i] = d_in[i];
    a.out = (float*)d_out; a.ws = (unsigned char*)d_ws;
    const int last = MK_LAST_PHASE + 1;
#if MK_N_LAUNCHES == 1
    a.ph_lo = 0; a.ph_hi = last;
    hipLaunchKernelGGL(skel_fwd, dim3(grid), dim3(NWAVES * 64), LDS_BYTES, stream, a);
#else
    for (int ph = 0; ph < last; ++ph) { a.ph_lo = ph; a.ph_hi = ph + 1; hipLaunchKernelGGL(skel_fwd, dim3(grid), dim3(NWAVES * 64), LDS_BYTES, stream, a); }
#endif
    const hipError_t le = hipPeekAtLastError();
    if (le != hipSuccess) fprintf(stderr, "kernel_launch: launch failed: %s\n", hipGetErrorName(le));
}
```
